# Optimizing an MI355X kernel written in HIP

```python
import jax, jax.numpy as jnp
from jax import lax
import numpy as np

D_MODEL = 1024
BATCH = 8
SEQ = 2048
DEPTH = 1

N_RET_HEADS = 8
RET_HEAD_DIM = D_MODEL // N_RET_HEADS
RET_WIDTH = N_RET_HEADS * RET_HEAD_DIM
RET_CHUNK = 128
ROPE_BASE = 10000.0
CONV_WIDTH = D_MODEL
CONV_GROUPS = 8
CONV_K = 3
FFN_HIDDEN = -(-8 * D_MODEL // (3 * 256)) * 256
EPS = 1e-6
N_MOD = 6
IN_SPLITS = [RET_WIDTH, RET_WIDTH, RET_WIDTH, RET_WIDTH,
             CONV_WIDTH, CONV_WIDTH, CONV_WIDTH,
             D_MODEL, D_MODEL]
IN_COLS = sum(IN_SPLITS)

kernel_name = "hybrid_retention_shortconv_block"


def rmsnorm(x, g):
    xf = x.astype(jnp.float32)
    y = xf * lax.rsqrt(jnp.mean(xf * xf, axis=-1, keepdims=True) + EPS)
    return (y * g.astype(jnp.float32)).astype(x.dtype)


def head_layernorm(y):
    yf = y.astype(jnp.float32)
    mu = jnp.mean(yf, axis=-1, keepdims=True)
    var = jnp.mean((yf - mu) ** 2, axis=-1, keepdims=True)
    return ((yf - mu) * lax.rsqrt(var + EPS)).astype(y.dtype)


def modulate(h, shift, scale):
    return h * (1.0 + scale[:, None, :]) + shift[:, None, :]


def rope(t, cos, sin):
    t1, t2 = jnp.split(t, 2, axis=-1)
    out = jnp.concatenate([t1 * cos - t2 * sin, t1 * sin + t2 * cos], axis=-1)
    return out.astype(t.dtype)


def retention_chunkwise(q, k, v, log_gamma):
    B, S, H, d = q.shape
    N = S // RET_CHUNK

    def to_chunks(t):
        return t.reshape(B, N, RET_CHUNK, H, t.shape[-1]).transpose(0, 3, 1, 2, 4)

    qc, kc, vc = to_chunks(q), to_chunks(k), to_chunks(v)
    idx = jnp.arange(RET_CHUNK, dtype=jnp.float32)
    rel = idx[:, None] - idx[None, :]
    lg = log_gamma[:, None, None]
    dmask = jnp.where(rel >= 0, jnp.exp(lg * jnp.maximum(rel, 0.0)), 0.0)
    scores = jnp.einsum('bhncd,bhnmd->bhncm', qc, kc) * dmask[None, :, None]
    inner = jnp.einsum('bhncm,bhnme->bhnce', scores, vc)
    zeta = jnp.exp(log_gamma[:, None] * (RET_CHUNK - 1 - idx)[None, :])
    kv = jnp.einsum('bhncd,bhnce->bhnde', kc * zeta[None, :, None, :, None], vc)
    chunk_decay = jnp.exp(log_gamma * RET_CHUNK)[None, :, None, None]

    def step(R, kv_n):
        return R * chunk_decay + kv_n, R

    _, R_prev = lax.scan(step, jnp.zeros_like(kv[:, :, 0]), kv.transpose(2, 0, 1, 3, 4))
    R_prev = R_prev.transpose(1, 2, 0, 3, 4)
    xi = jnp.exp(log_gamma[:, None] * (idx + 1.0)[None, :])
    cross = jnp.einsum('bhncd,bhnde->bhnce', qc, R_prev) * xi[None, :, None, :, None]
    out = inner + cross
    return out.transpose(0, 2, 3, 1, 4).reshape(B, S, H, vc.shape[-1])


def setup_inputs(seed: int = 0) -> dict:
    key = jax.random.key(seed)
    ks = jax.random.split(key, 20)
    D = D_MODEL
    nrm = lambda k, shape, fan_in, s=1.0: s * jax.random.normal(k, shape, jnp.float32) * fan_in ** -0.5
    x = jax.random.normal(ks[0], (BATCH, SEQ, D), jnp.float32)
    c = jax.random.normal(ks[1], (BATCH, D), jnp.float32)
    positions = jnp.broadcast_to(jnp.arange(SEQ, dtype=jnp.int32)[None, :], (BATCH, SEQ))
    return {
        "x": x,
        "c": c,
        "positions": positions,
        "ada_w": nrm(ks[2], (DEPTH, D, N_MOD * D), D, 0.1),
        "ada_b": 0.02 * jax.random.normal(ks[3], (DEPTH, N_MOD * D), jnp.float32),
        "norm_mix_g": 1.0 + 0.02 * jax.random.normal(ks[4], (DEPTH, D), jnp.float32),
        "w_in": nrm(ks[5], (DEPTH, D, IN_COLS), D),
        "conv_w": nrm(ks[6], (DEPTH, CONV_K, CONV_WIDTH), CONV_K),
        "ret_w_out": nrm(ks[7], (DEPTH, RET_WIDTH, D), RET_WIDTH),
        "conv_w_out": nrm(ks[8], (DEPTH, CONV_WIDTH, D), CONV_WIDTH),
        "mix_w_out": nrm(ks[9], (DEPTH, D, D), D),
        "norm_ffn_g": 1.0 + 0.02 * jax.random.normal(ks[10], (DEPTH, D), jnp.float32),
        "ffn_w_gate": nrm(ks[11], (DEPTH, D, FFN_HIDDEN), D),
        "ffn_w_up": nrm(ks[12], (DEPTH, D, FFN_HIDDEN), D),
        "ffn_w_down": nrm(ks[13], (DEPTH, FFN_HIDDEN, D), FFN_HIDDEN),
        "final_norm_g": 1.0 + 0.02 * jax.random.normal(ks[14], (D,), jnp.float32),
    }


def reference(x, c, positions, ada_w, ada_b, norm_mix_g, w_in, conv_w, ret_w_out,
              conv_w_out, mix_w_out, norm_ffn_g, ffn_w_gate, ffn_w_up, ffn_w_down,
              final_norm_g):
    B, S, D = x.shape
    H, d = N_RET_HEADS, RET_HEAD_DIM
    log_gamma = jnp.log(1.0 - 2.0 ** (-5.0 - jnp.arange(H, dtype=jnp.float32)))
    inv_freq = 1.0 / (ROPE_BASE ** (jnp.arange(0, d, 2, dtype=jnp.float32) / d))
    ang = positions.astype(jnp.float32)[..., None] * inv_freq
    cos, sin = jnp.cos(ang)[:, :, None, :], jnp.sin(ang)[:, :, None, :]
    split_pts = list(np.cumsum(IN_SPLITS)[:-1])
    cs = jax.nn.silu(c)

    for l in range(DEPTH):
        mod = cs @ ada_w[l] + ada_b[l]
        sh_m, sc_m, gt_m, sh_f, sc_f, gt_f = jnp.split(mod, N_MOD, axis=-1)

        h = modulate(rmsnorm(x, norm_mix_g[l]), sh_m, sc_m)
        proj = h @ w_in[l]
        q, k, v, g_ret, b_cv, c_cv, u_cv, g_a, g_b = jnp.split(proj, split_pts, axis=-1)

        q = rope(q.reshape(B, S, H, d), cos, sin)
        k = rope(k.reshape(B, S, H, d), cos, sin) * (d ** -0.5)
        v = v.reshape(B, S, H, d)
        y_ret = head_layernorm(retention_chunkwise(q, k, v, log_gamma)).reshape(B, S, RET_WIDTH)
        y_a = (jax.nn.silu(g_ret) * y_ret) @ ret_w_out[l]

        u = c_cv * u_cv
        u_pad = jnp.pad(u, ((0, 0), (CONV_K - 1, 0), (0, 0)))
        w = conv_w[l]
        conv = u_pad[:, 0:S] * w[0]
        for tap in range(1, CONV_K):
            conv = conv + u_pad[:, tap:tap + S] * w[tap]
        y_b = (b_cv * conv) @ conv_w_out[l]

        merged = jax.nn.sigmoid(g_a) * y_a + jax.nn.sigmoid(g_b) * y_b
        x = x + gt_m[:, None, :] * (merged @ mix_w_out[l])

        h = modulate(rmsnorm(x, norm_ffn_g[l]), sh_f, sc_f)
        f = (jax.nn.silu(h @ ffn_w_gate[l]) * (h @ ffn_w_up[l])) @ ffn_w_down[l]
        x = x + gt_f[:, None, :] * f

    return rmsnorm(x, final_norm_g)
```

```cpp
#include <hip/hip_runtime.h>
#include <hip/hip_cooperative_groups.h>
#include <cstdio>
#include <cstdint>
namespace cg = cooperative_groups;

#define LAS __attribute__((address_space(3)))
typedef unsigned short bf16_t;
typedef short bf16x8 __attribute__((ext_vector_type(8)));
typedef short s16x4 __attribute__((ext_vector_type(4)));
typedef float f32x4 __attribute__((ext_vector_type(4)));
typedef unsigned u32x4 __attribute__((ext_vector_type(4)));
typedef unsigned u32x2 __attribute__((ext_vector_type(2)));

constexpr int T_ = 16384, D_ = 1024, FH = 2816;
constexpr float EPS = 1e-6f;
constexpr size_t MiB = (size_t)1 << 20;
constexpr size_t WS_WIN = 0;
constexpr size_t WS_WGU = 0;
constexpr size_t WS_WD = 11 * MiB;
constexpr size_t WS_WR = 18 * MiB;
constexpr size_t WS_WC = 20 * MiB;
constexpr size_t WS_WMIX = 22 * MiB;
constexpr size_t WS_CTL = 24 * MiB;
constexpr size_t WS_MOD = WS_CTL + 65536;
constexpr size_t WS_SS1 = WS_MOD + 196608;
constexpr size_t WS_SS2 = WS_SS1 + 65536;
constexpr size_t WS_SLOT = 25 * MiB;
constexpr size_t SLOT = 32 * MiB;
constexpr size_t WS_END = WS_SLOT + 7 * SLOT;
constexpr int LDS_BAR_OFF = 131072;
constexpr int LDS_BYTES = 131072 + 256;

struct Params {
    const float* x; const float* c; const int* pos; const float* ada_w; const float* ada_b; const float* g_mix; const float* w_in; const float* conv_w;
    const float* w_ret; const float* w_conv; const float* w_mix; const float* g_ffn; const float* w_gate; const float* w_up; const float* w_down; const float* g_fin;
    float* out; unsigned char* ws; int never; int pad;
};

__device__ __forceinline__ unsigned cvt_pk_bf16(float lo, float hi) { unsigned r; asm volatile("v_cvt_pk_bf16_f32 %0, %1, %2" : "=v"(r) : "v"(lo), "v"(hi)); return r; }
__device__ __forceinline__ float bf_lo(unsigned u) { return __uint_as_float(u << 16); }
__device__ __forceinline__ float bf_hi(unsigned u) { return __uint_as_float(u & 0xffff0000u); }
__device__ __forceinline__ float fast_rcp(float x) { return __builtin_amdgcn_rcpf(x); }
__device__ __forceinline__ float sigmoidf_(float x) { return fast_rcp(1.0f + __expf(-x)); }
__device__ __forceinline__ float siluf_(float x) { return x * sigmoidf_(x); }
#define LDS_WAIT() asm volatile("s_waitcnt lgkmcnt(0)" ::: "memory")

#define XB_TMO      128
#define XB_XCNT(j)  (256  + 64 * (j))
#define XB_XSUB(j)  (1280 + 64 * (j))
#define XB_XGEN(j)  (2304 + 64 * (j))
#define XB_TOP      3328
#define XB_TOPGEN   3392
#define XCD_BAR_WORDS 3456
#define XB_SPIN_CAP (1u << 22)
__device__ __forceinline__ unsigned xb_ld(unsigned* p)              { return __hip_atomic_load(p, __ATOMIC_RELAXED, __HIP_MEMORY_SCOPE_AGENT); }
__device__ __forceinline__ unsigned xb_add(unsigned* p, unsigned v) { return __hip_atomic_fetch_add(p, v, __ATOMIC_RELAXED, __HIP_MEMORY_SCOPE_AGENT); }
__device__ __forceinline__ unsigned xb_xcc_id() { return (unsigned)__builtin_amdgcn_s_getreg((3 << 11) | 20) & 0xFu; }
#define XB_SPIN(cond, bar) do { unsigned _sp = 0; while (cond) { __builtin_amdgcn_s_sleep(1); \
    if ((++_sp & 255u) == 0u) { if (xb_ld(&(bar)[XB_TMO])) break; if (_sp > XB_SPIN_CAP) { atomicAdd(&(bar)[XB_TMO], 1u); break; } } } } while (0)
struct XcdBarrier { unsigned* bar; unsigned x; volatile LAS unsigned* st; };
__device__ __forceinline__ XcdBarrier xcd_barrier_post(unsigned* bar, volatile LAS unsigned* st) {
    XcdBarrier b; b.bar = bar; b.x = xb_xcc_id(); b.st = st;
    if (threadIdx.x == 0) (void)xb_add(&bar[XB_XCNT(b.x)], 1u);
    return b;
}
__device__ __forceinline__ void xcd_barrier_complete(unsigned* bar, unsigned x, unsigned& nloc, unsigned& nx) {
    const unsigned G = gridDim.x * gridDim.y * gridDim.z;
    unsigned sum, cnt, mine, sp = 0u;
    for (;;) {
        sum = 0u; cnt = 0u; mine = 0u;
#pragma unroll
        for (unsigned j = 0; j < 16; ++j) { const unsigned c = xb_ld(&bar[XB_XCNT(j)]); sum += c; cnt += (c > 0u) ? 1u : 0u; mine = (j == x) ? c : mine; }
        if (sum == G) break;
        __builtin_amdgcn_s_sleep(1);
        if ((++sp & 255u) == 0u) { if (xb_ld(&bar[XB_TMO])) break; if (sp > XB_SPIN_CAP) { atomicAdd(&bar[XB_TMO], 1u); break; } }
    }
    nloc = mine > 0u ? mine : 1u; nx = cnt > 0u ? cnt : 1u;
}
__device__ __forceinline__ void xcd_barrier(const XcdBarrier& b) {
    asm volatile("s_waitcnt vmcnt(0)" ::: "memory");
    __syncthreads();
    if (threadIdx.x == 0) {
        unsigned* bar = b.bar;
        __builtin_amdgcn_s_waitcnt(0);
        unsigned nloc = b.st[0], nx = b.st[1];
        if (nloc == 0u) { xcd_barrier_complete(bar, b.x, nloc, nx); b.st[0] = nloc; b.st[1] = nx; }
        const unsigned old = xb_add(&bar[XB_XSUB(b.x)], 1u);
        const unsigned gen = old / nloc;
        if (old + 1u == (gen + 1u) * nloc) {
            __builtin_amdgcn_fence(__ATOMIC_RELEASE, "agent");
            asm volatile("s_waitcnt vmcnt(0)" ::: "memory");
            const unsigned og = xb_add(&bar[XB_TOP], 1u);
            const unsigned tg = og / nx;
            if (og + 1u == (tg + 1u) * nx) xb_add(&bar[XB_TOPGEN], 1u);
            else XB_SPIN(xb_ld(&bar[XB_TOPGEN]) == tg, bar);
            __builtin_amdgcn_fence(__ATOMIC_ACQUIRE, "agent");
            xb_add(&bar[XB_XGEN(b.x)], 1u);
            asm volatile("s_waitcnt vmcnt(0)" ::: "memory");
        } else {
            XB_SPIN(xb_ld(&bar[XB_XGEN(b.x)]) == gen, bar);
            __builtin_amdgcn_fence(__ATOMIC_ACQUIRE, "agent");
            asm volatile("s_waitcnt vmcnt(0)" ::: "memory");
        }
    }
    __syncthreads();
}

constexpr int BM = 256, BK = 64, HALF = 128, HTB = HALF * BK * 2, NXCD = 8, WGM = 8;
__device__ __forceinline__ int lds_byte(int r, int c) { const int st = (r >> 4) * 2 + (c >> 5), rr = r & 15, cc = c & 31, ob = rr * 64 + cc * 2; return st * 1024 + (ob ^ (((ob >> 9) & 1) << 5)); }
__device__ __forceinline__ void stage_rc(int b, int& R, int& C) { const int st = b / 1024, sb = b % 1024, swz = sb ^ (((sb >> 9) & 1) << 5); R = (st >> 1) * 16 + swz / 64; C = (st & 1) * 32 + (swz % 64) / 2; }
__device__ __forceinline__ int perm32(int rho) { const int n = rho >> 4, i = rho & 15; return 8 * (i >> 2) + 4 * n + (i & 3); }

struct Unit { int pm, pn, sel, cont; };
struct Gemm { const bf16_t* A; const bf16_t* Bt; const bf16_t* A2; const bf16_t* Bt2; int K; };
struct Order {
    int nM, nN, nwg, G, c, dup;
    __device__ __forceinline__ bool next(int i, Unit& u) const {
        const int ti = (dup == 2) ? (i >> 1) : i;
        const long L = (long)ti * G + c; if (L >= nwg) return false;
        int wgid = (int)L; { const int q = nwg / NXCD, r = nwg % NXCD, xcd = wgid % NXCD, off = wgid / NXCD; wgid = (xcd < r ? xcd * (q + 1) : r * (q + 1) + (xcd - r) * q) + off; }
        const int nig = WGM * nN, gid = wgid / nig, fm = gid * WGM, gsz = (nM - fm) < WGM ? (nM - fm) : WGM;
        u.pm = fm + ((wgid % nig) % gsz); u.pn = (wgid % nig) / gsz;
        u.sel = (dup == 2) ? (i & 1) : 0; u.cont = (dup == 2) ? ((i & 1) == 0) : 0;
        return true;
    }
};

template <class Epi>
__device__ __forceinline__ void gemm_phase(LAS unsigned char* lds, const Gemm g, const Order& S, const Epi& E) {
    int tid = threadIdx.x; asm volatile("" : "+v"(tid));
    const int wid = __builtin_amdgcn_readfirstlane(tid >> 6), lane = tid & 63, wr = wid >> 2, wc = wid & 3, fr = lane & 15, fq = lane >> 4;
    const int K = g.K, nt = K / BK;
    unsigned voffA[2], voffB[2];
#pragma unroll
    for (int i = 0; i < 2; ++i) { int R, C; stage_rc(tid * 16 + i * 8192, R, C); const int Rb = Epi::PERM ? ((R & ~31) + perm32(R & 31)) : R;
        voffA[i] = (unsigned)(R * K + C) * 2u; voffB[i] = (unsigned)(Rb * K + C) * 2u; }
    const size_t kstep = (size_t)(BK * 2);
    const size_t hstep = (size_t)HALF * K * 2;
    const size_t tstep = 2 * hstep;
    const unsigned ldsw = (unsigned)wid * 1024u;
    const int aoff = lds_byte(wr * 64 + fr, fq * 8), boff = lds_byte(wc * 32 + fr, fq * 8);
#define PG8_SA(b, h) (((b) * 2 + (h)) * HTB)
#define PG8_SB(b, h) ((4 + (b) * 2 + (h)) * HTB)
#define PG8_STAGE(bufoff, gbase, voff) do { _Pragma("unroll") for (int _i = 0; _i < 2; ++_i) \
        __builtin_amdgcn_global_load_lds((const unsigned*)((const char*)(gbase) + (voff)[_i]), (LAS unsigned*)(lds + (bufoff) + ldsw + _i * 8192), 16, 0, 0); } while (0)
#define PG8_LDA(dst, b, h) do { _Pragma("unroll") for (int m = 0; m < 4; ++m) _Pragma("unroll") for (int k = 0; k < 2; ++k) dst[m][k] = *(const LAS bf16x8*)(lds + PG8_SA(b, h) + aoff + m * 2048 + k * 1024); } while (0)
#define PG8_LDB(dst, b, h) do { _Pragma("unroll") for (int n = 0; n < 2; ++n) _Pragma("unroll") for (int k = 0; k < 2; ++k) dst[n][k] = *(const LAS bf16x8*)(lds + PG8_SB(b, h) + boff + n * 2048 + k * 1024); } while (0)
#define PG8_MMA(ai, bj, At, Bt) do { __builtin_amdgcn_s_setprio(1); _Pragma("unroll") for (int m = 0; m < 4; ++m) _Pragma("unroll") for (int n = 0; n < 2; ++n) _Pragma("unroll") for (int k = 0; k < 2; ++k) \
        acc[ai][bj][m][n] = __builtin_amdgcn_mfma_f32_16x16x32_bf16(Bt[n][k], At[m][k], acc[ai][bj][m][n], 0, 0, 0); __builtin_amdgcn_s_setprio(0); } while (0)
#define PG8_WAIT_V(n) asm volatile("s_waitcnt vmcnt(" #n ")" ::: "memory")
#define PG8_WAIT_L(n) asm volatile("s_waitcnt lgkmcnt(" #n ")" ::: "memory")
#define PG8_BAR __builtin_amdgcn_s_barrier()
#define PG8_SCHED __builtin_amdgcn_sched_barrier(0)
    Unit cur, nxt; int ui = 0;
    if (!S.next(0, cur)) return;
    f32x4 acc[2][2][4][2];
#pragma unroll
    for (int a = 0; a < 2; ++a)
#pragma unroll
        for (int b = 0; b < 2; ++b)
#pragma unroll
            for (int m = 0; m < 4; ++m)
#pragma unroll
                for (int n = 0; n < 2; ++n) acc[a][b][m][n] = (f32x4){0.f, 0.f, 0.f, 0.f};
    bf16x8 At[4][2], B0[2][2], B1[2][2];
    const char* cA = (const char*)(cur.sel ? g.A2 : g.A) + (size_t)cur.pm * tstep; const char* cB = (const char*)(cur.sel ? g.Bt2 : g.Bt) + (size_t)cur.pn * tstep;
    PG8_STAGE(PG8_SB(0, 0), cB, voffB); PG8_STAGE(PG8_SA(0, 0), cA, voffA); PG8_STAGE(PG8_SB(0, 1), cB + hstep, voffB); PG8_STAGE(PG8_SA(0, 1), cA + hstep, voffA);
    if (wr == 1) PG8_BAR;
    PG8_WAIT_V(4); PG8_BAR;
    PG8_STAGE(PG8_SB(1, 0), cB + kstep, voffB); PG8_STAGE(PG8_SA(1, 0), cA + kstep, voffA); PG8_STAGE(PG8_SB(1, 1), cB + hstep + kstep, voffB);
    PG8_WAIT_V(6); PG8_BAR;
    for (;;) {
        const bool has_next = S.next(ui + 1, nxt);
        const char* nA = has_next ? (const char*)(nxt.sel ? g.A2 : g.A) + (size_t)nxt.pm * tstep : cA; const char* nB = has_next ? (const char*)(nxt.sel ? g.Bt2 : g.Bt) + (size_t)nxt.pn * tstep : cB;
        for (int t = 0; t < nt; t += 2) {
            const bool last = (t == nt - 2);
            const char* a1 = cA + (size_t)(t + 1) * kstep;
            const char* a2 = last ? nA : cA + (size_t)(t + 2) * kstep; const char* b2 = last ? nB : cB + (size_t)(t + 2) * kstep;
            const char* a3 = a2 + kstep; const char* b3 = b2 + kstep;
            PG8_LDB(B0, 0, 0); PG8_SCHED; PG8_LDA(At, 0, 0); PG8_STAGE(PG8_SA(1, 1), a1 + hstep, voffA);
            PG8_WAIT_L(8); PG8_BAR; PG8_WAIT_L(0); PG8_MMA(0, 0, At, B0); PG8_BAR; PG8_SCHED;
            PG8_LDB(B1, 0, 1); PG8_STAGE(PG8_SB(0, 0), b2, voffB);
            PG8_BAR; PG8_WAIT_L(0); PG8_MMA(0, 1, At, B1); PG8_BAR;
            PG8_LDA(At, 0, 1); PG8_STAGE(PG8_SA(0, 0), a2, voffA);
            PG8_BAR; PG8_WAIT_L(0); PG8_MMA(1, 0, At, B0); PG8_BAR; PG8_SCHED;
            PG8_STAGE(PG8_SB(0, 1), b2 + hstep, voffB);
            PG8_WAIT_V(6); PG8_BAR; PG8_MMA(1, 1, At, B1); PG8_BAR;
            PG8_LDB(B0, 1, 0); PG8_SCHED; PG8_LDA(At, 1, 0); PG8_STAGE(PG8_SA(0, 1), a2 + hstep, voffA);
            PG8_WAIT_L(8); PG8_BAR; PG8_WAIT_L(0); PG8_MMA(0, 0, At, B0); PG8_BAR; PG8_SCHED;
            PG8_LDB(B1, 1, 1); PG8_STAGE(PG8_SB(1, 0), b3, voffB);
            PG8_BAR; PG8_WAIT_L(0); PG8_MMA(0, 1, At, B1); PG8_BAR;
            PG8_LDA(At, 1, 1); PG8_STAGE(PG8_SA(1, 0), a3, voffA);
            PG8_BAR; PG8_WAIT_L(0); PG8_MMA(1, 0, At, B0); PG8_BAR; PG8_SCHED;
            PG8_STAGE(PG8_SB(1, 1), b3 + hstep, voffB);
            PG8_WAIT_V(6); PG8_BAR; PG8_MMA(1, 1, At, B1); PG8_BAR;
        }
        E(acc, cur, wr, wc, fr, fq);
        if (!has_next) break;
        if (!cur.cont) {
#pragma unroll
            for (int a = 0; a < 2; ++a)
#pragma unroll
                for (int b = 0; b < 2; ++b)
#pragma unroll
                    for (int m = 0; m < 4; ++m)
#pragma unroll
                        for (int n = 0; n < 2; ++n) acc[a][b][m][n] = (f32x4){0.f, 0.f, 0.f, 0.f};
        }
        cur = nxt; cA = nA; cB = nB; ++ui;
    }
    PG8_WAIT_V(0);
    if (wr == 0) PG8_BAR;
    PG8_BAR;
#undef PG8_SA
#undef PG8_SB
#undef PG8_STAGE
#undef PG8_LDA
#undef PG8_LDB
#undef PG8_MMA
#undef PG8_WAIT_V
#undef PG8_WAIT_L
#undef PG8_BAR
#undef PG8_SCHED
}

struct EpiInProj {
    static constexpr bool PERM = true;
    bf16_t *sbase, *u, *gbase; const int* pos;
    __device__ __forceinline__ void operator()(f32x4 (&acc)[2][2][4][2], const Unit& un, int wr, int wc, int fr, int fq) const {
        const int pn = un.pn;
        const int rbase = un.pm * BM + wr * 64 + fr;
        const int cp = wc * 32 + 8 * fq;
        if (pn < 8) {
            const bool isk = pn >= 4;
            const int head = 2 * (pn & 3) + (wc >> 1), i0 = (wc & 1) * 32 + 8 * fq;
            bf16_t* dst = sbase + (size_t)(pn >> 2) * (SLOT / 2);
            float invf[8];
#pragma unroll
            for (int e = 0; e < 8; ++e) invf[e] = exp2f(-(float)(i0 + e) * 0.20762050593046014f) * 0.15915494309189535f;
            const float lg = log2f(1.0f - exp2f(-5.0f - (float)head));
            const float lgs = isk ? -lg : lg;
#pragma unroll
            for (int ai = 0; ai < 2; ++ai)
#pragma unroll
                for (int m = 0; m < 4; ++m) {
                    const int row = rbase + ai * HALF + m * 16;
                    const float pf = (float)pos[row];
                    float sc = exp2f(lgs * (float)(row & 127));
                    if (isk) sc *= 0.08838834764831845f;
                    float o1[8], o2[8];
#pragma unroll
                    for (int e = 0; e < 8; ++e) {
                        const float t1 = acc[ai][0][m][e >> 2][e & 3], t2 = acc[ai][1][m][e >> 2][e & 3];
                        float rv = pf * invf[e]; rv = rv - floorf(rv);
                        const float sn = __builtin_amdgcn_sinf(rv), cs = __builtin_amdgcn_cosf(rv);
                        o1[e] = (t1 * cs - t2 * sn) * sc; o2[e] = (t1 * sn + t2 * cs) * sc;
                    }
                    bf16_t* rp = dst + (size_t)row * D_ + head * 128 + i0;
                    u32x4 w1, w2;
                    w1.x = cvt_pk_bf16(o1[0], o1[1]); w1.y = cvt_pk_bf16(o1[2], o1[3]); w1.z = cvt_pk_bf16(o1[4], o1[5]); w1.w = cvt_pk_bf16(o1[6], o1[7]);
                    w2.x = cvt_pk_bf16(o2[0], o2[1]); w2.y = cvt_pk_bf16(o2[2], o2[3]); w2.z = cvt_pk_bf16(o2[4], o2[5]); w2.w = cvt_pk_bf16(o2[6], o2[7]);
                    *(u32x4*)rp = w1; *(u32x4*)(rp + 64) = w2;
                }
        } else if (pn >= 20 && pn < 28) {
            const int ch0 = (pn - 20) * 128 + cp;
#pragma unroll
            for (int ai = 0; ai < 2; ++ai)
#pragma unroll
                for (int m = 0; m < 4; ++m) {
                    const int row = rbase + ai * HALF + m * 16;
                    const f32x4 a0 = acc[ai][0][m][0] * acc[ai][1][m][0], a1 = acc[ai][0][m][1] * acc[ai][1][m][1];
                    u32x4 w; w.x = cvt_pk_bf16(a0[0], a0[1]); w.y = cvt_pk_bf16(a0[2], a0[3]); w.z = cvt_pk_bf16(a1[0], a1[1]); w.w = cvt_pk_bf16(a1[2], a1[3]);
                    *(u32x4*)(u + (size_t)row * D_ + ch0) = w;
                }
        } else {
            const int sidx = pn >> 2;
            const int act = (sidx == 3) ? 1 : (sidx >= 7 ? 2 : 0);
            bf16_t* dst = (sidx >= 7) ? gbase + (size_t)(sidx - 7) * ((size_t)T_ * D_) : sbase + (size_t)sidx * (SLOT / 2);
            const int col0 = (pn & 3) * 256 + cp;
#pragma unroll
            for (int ai = 0; ai < 2; ++ai)
#pragma unroll
                for (int m = 0; m < 4; ++m) {
                    const int row = rbase + ai * HALF + m * 16;
#pragma unroll
                    for (int bj = 0; bj < 2; ++bj) {
                        f32x4 a0 = acc[ai][bj][m][0], a1 = acc[ai][bj][m][1];
                        if (act == 1) {
#pragma unroll
                            for (int j = 0; j < 4; ++j) { a0[j] = siluf_(a0[j]); a1[j] = siluf_(a1[j]); }
                        } else if (act == 2) {
#pragma unroll
                            for (int j = 0; j < 4; ++j) { a0[j] = sigmoidf_(a0[j]); a1[j] = sigmoidf_(a1[j]); }
                        }
                        u32x4 w; w.x = cvt_pk_bf16(a0[0], a0[1]); w.y = cvt_pk_bf16(a0[2], a0[3]); w.z = cvt_pk_bf16(a1[0], a1[1]); w.w = cvt_pk_bf16(a1[2], a1[3]);
                        *(u32x4*)(dst + (size_t)row * D_ + col0 + bj * HALF) = w;
                    }
                }
        }
    }
};

struct EpiMerge {
    static constexpr bool PERM = true;
    const bf16_t *ga, *gb; bf16_t* merged;
    __device__ __forceinline__ void operator()(f32x4 (&acc)[2][2][4][2], const Unit& un, int wr, int wc, int fr, int fq) const {
        const int rbase = un.pm * BM + wr * 64 + fr, col0 = un.pn * BM + wc * 32 + 8 * fq;
#pragma unroll
        for (int ai = 0; ai < 2; ++ai)
#pragma unroll
            for (int m = 0; m < 4; ++m) {
                const size_t off = (size_t)(rbase + ai * HALF + m * 16) * D_ + col0;
#pragma unroll
                for (int bj = 0; bj < 2; ++bj) {
                    const u32x4 gbv = *(const u32x4*)(gb + off + bj * HALF);
                    float sb[8] = {bf_lo(gbv.x), bf_hi(gbv.x), bf_lo(gbv.y), bf_hi(gbv.y), bf_lo(gbv.z), bf_hi(gbv.z), bf_lo(gbv.w), bf_hi(gbv.w)};
                    if (un.sel == 0) {
                        const u32x4 gav = *(const u32x4*)(ga + off + bj * HALF);
                        float sa[8] = {bf_lo(gav.x), bf_hi(gav.x), bf_lo(gav.y), bf_hi(gav.y), bf_lo(gav.z), bf_hi(gav.z), bf_lo(gav.w), bf_hi(gav.w)};
#pragma unroll
                        for (int e = 0; e < 8; ++e) acc[ai][bj][m][e >> 2][e & 3] *= sa[e] / sb[e];
                    } else {
                        float o[8];
#pragma unroll
                        for (int e = 0; e < 8; ++e) o[e] = acc[ai][bj][m][e >> 2][e & 3] * sb[e];
                        u32x4 w; w.x = cvt_pk_bf16(o[0], o[1]); w.y = cvt_pk_bf16(o[2], o[3]); w.z = cvt_pk_bf16(o[4], o[5]); w.w = cvt_pk_bf16(o[6], o[7]);
                        *(u32x4*)(merged + off + bj * HALF) = w;
                    }
                }
            }
    }
};

struct EpiResid {
    static constexpr bool PERM = false;
    const float* xi; float* xo; const float* gate; float* ss;
    __device__ __forceinline__ void operator()(f32x4 (&acc)[2][2][4][2], const Unit& un, int wr, int wc, int fr, int fq) const {
        const int rbase = un.pm * BM + wr * 64 + fr, col0 = un.pn * BM + wc * 32 + 4 * fq;
#pragma unroll
        for (int ai = 0; ai < 2; ++ai)
#pragma unroll
            for (int m = 0; m < 4; ++m) {
                const int row = rbase + ai * HALF + m * 16;
                const float* gp = gate + (size_t)(row >> 11) * 6144 + col0;
                const size_t off = (size_t)row * D_ + col0;
                float s = 0.f;
#pragma unroll
                for (int bj = 0; bj < 2; ++bj)
#pragma unroll
                    for (int n = 0; n < 2; ++n) {
                        const f32x4 xv = *(const f32x4*)(xi + off + bj * HALF + n * 16);
                        const f32x4 gv = *(const f32x4*)(gp + bj * HALF + n * 16);
                        const f32x4 o = xv + gv * acc[ai][bj][m][n];
                        *(f32x4*)(xo + off + bj * HALF + n * 16) = o;
                        s += (o[0] * o[0] + o[1] * o[1]) + (o[2] * o[2] + o[3] * o[3]);
                    }
                s += __shfl_xor(s, 16); s += __shfl_xor(s, 32);
                if (fq == 0) atomicAdd(ss + row, s);
            }
    }
};

struct EpiGU {
    static constexpr bool PERM = true;
    bf16_t* act;
    __device__ __forceinline__ void operator()(f32x4 (&acc)[2][2][4][2], const Unit& un, int wr, int wc, int fr, int fq) const {
        const int rbase = un.pm * BM + wr * 64 + fr, col0 = un.pn * 128 + wc * 32 + 8 * fq;
#pragma unroll
        for (int ai = 0; ai < 2; ++ai)
#pragma unroll
            for (int m = 0; m < 4; ++m) {
                const int row = rbase + ai * HALF + m * 16;
                float o[8];
#pragma unroll
                for (int e = 0; e < 8; ++e) o[e] = siluf_(acc[ai][0][m][e >> 2][e & 3]) * acc[ai][1][m][e >> 2][e & 3];
                u32x4 w; w.x = cvt_pk_bf16(o[0], o[1]); w.y = cvt_pk_bf16(o[2], o[3]); w.z = cvt_pk_bf16(o[4], o[5]); w.w = cvt_pk_bf16(o[6], o[7]);
                *(u32x4*)(act + (size_t)row * FH + col0) = w;
            }
    }
};

__device__ __forceinline__ void transpose_item(const float* src, int ldsrc, bf16_t* dst, int lddst, LAS float* scr, int lane) {
#pragma unroll 8
    for (int i = 0; i < 32; ++i) { const int kk = 2 * i + (lane >> 5); scr[kk * 33 + (lane & 31)] = src[(size_t)kk * ldsrc + (lane & 31)]; }
    LDS_WAIT();
    const int c = lane & 7;
#pragma unroll
    for (int j = 0; j < 4; ++j) { const int n = (lane >> 3) + 8 * j; const LAS float* s = scr + (8 * c) * 33 + n;
        u32x4 o; o.x = cvt_pk_bf16(s[0 * 33], s[1 * 33]); o.y = cvt_pk_bf16(s[2 * 33], s[3 * 33]); o.z = cvt_pk_bf16(s[4 * 33], s[5 * 33]); o.w = cvt_pk_bf16(s[6 * 33], s[7 * 33]);
        *(u32x4*)(dst + (size_t)n * lddst + 8 * c) = o; }
    LDS_WAIT();
}
__device__ __forceinline__ int map_in(int j) {
    const int pn = j >> 8, c = j & 255, bj = c >> 7, cp = c & 127;
    if (pn < 8) { const int base = (pn >= 4) ? 1024 : 0, head = 2 * (pn & 3) + (cp >> 6), i = cp & 63; return base + head * 128 + i + 64 * bj; }
    if (pn >= 20 && pn < 28) return (bj ? 6144 : 5120) + (pn - 20) * 128 + cp;
    return j;
}

constexpr int IMG_STRIDE = 288;
constexpr int KIMG = 0, VIMG = 128 * IMG_STRIDE, RIMG = 2 * 128 * IMG_STRIDE;
__device__ __forceinline__ bf16x8 tr_frag(LAS unsigned char* img, int row_lo, int row_hi, int colbyte) {
    const s16x4 lo = __builtin_amdgcn_ds_read_tr16_b64_v4i16((LAS s16x4*)(img + row_lo * IMG_STRIDE + colbyte));
    const s16x4 hi = __builtin_amdgcn_ds_read_tr16_b64_v4i16((LAS s16x4*)(img + row_hi * IMG_STRIDE + colbyte));
    return __builtin_shufflevector(lo, hi, 0, 1, 2, 3, 4, 5, 6, 7);
}
__device__ __forceinline__ void kv_update(LAS unsigned char* lds, f32x4 (&accR)[8], int w, int lane) {
    const int g4 = lane >> 4, q = (lane & 15) >> 2, p = lane & 3;
    bf16x8 af[4];
#pragma unroll
    for (int s = 0; s < 4; ++s) af[s] = tr_frag(lds + KIMG, 32 * s + 8 * g4 + q, 32 * s + 8 * g4 + 4 + q, (16 * w + 4 * p) * 2);
#pragma unroll
    for (int et = 0; et < 8; ++et)
#pragma unroll
        for (int s = 0; s < 4; ++s) {
            const bf16x8 bfr = tr_frag(lds + VIMG, 32 * s + 8 * g4 + q, 32 * s + 8 * g4 + 4 + q, (16 * et + 4 * p) * 2);
            accR[et] = __builtin_amdgcn_mfma_f32_16x16x32_bf16(af[s], bfr, accR[et], 0, 0, 0);
        }
}

__global__ void __launch_bounds__(512, 2) mega(Params p) {
    extern __shared__ __attribute__((aligned(16))) unsigned char smem[];
    LAS unsigned char* lds = (LAS unsigned char*)smem;
    const int tid = threadIdx.x, lane = tid & 63, wave = __builtin_amdgcn_readfirstlane(tid >> 6);
    const int G = gridDim.x, bid = blockIdx.x;
    unsigned char* ws = p.ws;
    if (p.never) cg::this_grid().sync();
    volatile LAS unsigned* stw = (volatile LAS unsigned*)(lds + LDS_BAR_OFF);
    if (tid < 4) stw[tid] = 0u;
    __syncthreads();
    XcdBarrier bar = xcd_barrier_post((unsigned*)(ws + WS_CTL), stw);

    bf16_t* const Win = (bf16_t*)(ws + WS_WIN);
    bf16_t* const Wgu = (bf16_t*)(ws + WS_WGU);
    bf16_t* const Wd = (bf16_t*)(ws + WS_WD);
    bf16_t* const Wr = (bf16_t*)(ws + WS_WR);
    bf16_t* const Wc = (bf16_t*)(ws + WS_WC);
    bf16_t* const Wmix = (bf16_t*)(ws + WS_WMIX);
    float* const mod = (float*)(ws + WS_MOD);
    float* const ss1 = (float*)(ws + WS_SS1);
    float* const ss2 = (float*)(ws + WS_SS2);
    bf16_t* const S0 = (bf16_t*)(ws + WS_SLOT + 0 * SLOT);
    bf16_t* const S1 = (bf16_t*)(ws + WS_SLOT + 1 * SLOT);
    bf16_t* const S2 = (bf16_t*)(ws + WS_SLOT + 2 * SLOT);
    bf16_t* const S3 = (bf16_t*)(ws + WS_SLOT + 3 * SLOT);
    bf16_t* const S4 = (bf16_t*)(ws + WS_SLOT + 4 * SLOT);
    bf16_t* const S5 = (bf16_t*)(ws + WS_SLOT + 5 * SLOT);
    bf16_t* const S6 = (bf16_t*)(ws + WS_SLOT + 6 * SLOT);
    bf16_t* const GA = (bf16_t*)p.out;
    bf16_t* const GB = GA + (size_t)T_ * D_;
    float* const Gbuf = (float*)S0;

    {
        for (int i = bid * 512 + tid; i < T_; i += G * 512) { ss1[i] = 0.f; ss2[i] = 0.f; }
        if (bid < 96) {
            LAS float* cs = (LAS float*)(lds + 69632);
            LAS float* red = (LAS float*)(lds + 69632 + 32768);
            for (int i = tid; i < 8192; i += 512) cs[i] = siluf_(p.c[i]);
            __syncthreads();
            const int cgp = tid & 15, kl = tid >> 4;
            float a[8][4];
#pragma unroll
            for (int b = 0; b < 8; ++b)
#pragma unroll
                for (int j = 0; j < 4; ++j) a[b][j] = 0.f;
            const float* wp = p.ada_w + 64 * bid + 4 * cgp;
            for (int kk = 0; kk < 32; ++kk) {
                const int k = kl + 32 * kk;
                const f32x4 w = *(const f32x4*)(wp + (size_t)k * 6144);
#pragma unroll
                for (int b = 0; b < 8; ++b) { const float cv = cs[b * 1024 + k]; a[b][0] += cv * w[0]; a[b][1] += cv * w[1]; a[b][2] += cv * w[2]; a[b][3] += cv * w[3]; }
            }
#pragma unroll
            for (int b = 0; b < 8; ++b)
#pragma unroll
                for (int j = 0; j < 4; ++j) { float v = a[b][j]; v += __shfl_xor(v, 16); v += __shfl_xor(v, 32); a[b][j] = v; }
            if (lane < 16) {
#pragma unroll
                for (int b = 0; b < 8; ++b)
#pragma unroll
                    for (int j = 0; j < 4; ++j) red[(wave * 16 + cgp) * 32 + b * 4 + j] = a[b][j];
            }
            __syncthreads();
            {
                const int b = tid >> 6, col = tid & 63, cg2 = col >> 2, j = col & 3;
                float v = 0.f;
#pragma unroll
                for (int w8 = 0; w8 < 8; ++w8) v += red[(w8 * 16 + cg2) * 32 + b * 4 + j];
                mod[b * 6144 + 64 * bid + col] = v + p.ada_b[64 * bid + col];
            }
            __syncthreads();
        }
        LAS float* scr = (LAS float*)(lds + wave * 8448);
        const int gw = bid * 8 + wave, NGW = G * 8;
        constexpr int I_IN = 16 * 288, I_SQ = 16 * 32;
        for (int it = gw; it < I_IN + 3 * I_SQ; it += NGW) {
            int r = it;
            if (r < I_IN) { const int kb = r / 288, nb = r % 288; transpose_item(p.w_in + (size_t)(64 * kb) * 9216 + map_in(32 * nb), 9216, Win + (size_t)(32 * nb) * 1024 + 64 * kb, 1024, scr, lane); continue; }
            r -= I_IN;
            const float* src = r < I_SQ ? p.w_ret : (r < 2 * I_SQ ? p.w_conv : p.w_mix);
            bf16_t* dst = r < I_SQ ? Wr : (r < 2 * I_SQ ? Wc : Wmix);
            r %= I_SQ;
            const int kb = r / 32, nb = r % 32;
            transpose_item(src + (size_t)(64 * kb) * 1024 + 32 * nb, 1024, dst + (size_t)(32 * nb) * 1024 + 64 * kb, 1024, scr, lane);
        }
    }
    xcd_barrier(bar);

    {
        const int gw = bid * 8 + wave, NGW = G * 8;
        for (int row = gw; row < T_; row += NGW) {
            const float* xr = p.x + (size_t)row * D_;
            const float* mb = mod + (size_t)(row >> 11) * 6144;
            f32x4 v[4]; float s = 0.f;
#pragma unroll
            for (int j = 0; j < 4; ++j) { v[j] = *(const f32x4*)(xr + 4 * lane + 256 * j); s += (v[j][0] * v[j][0] + v[j][1] * v[j][1]) + (v[j][2] * v[j][2] + v[j][3] * v[j][3]); }
#pragma unroll
            for (int o = 1; o < 64; o <<= 1) s += __shfl_xor(s, o);
            const float rstd = 1.0f / sqrtf(s * (1.0f / D_) + EPS);
#pragma unroll
            for (int j = 0; j < 4; ++j) {
                const int c0 = 4 * lane + 256 * j;
                const f32x4 gv = *(const f32x4*)(p.g_mix + c0), sh = *(const f32x4*)(mb + c0), sc = *(const f32x4*)(mb + 1024 + c0);
                const f32x4 y = (v[j] * rstd) * gv;
                const f32x4 o = y * (sc + 1.0f) + sh;
                u32x2 w; w.x = cvt_pk_bf16(o[0], o[1]); w.y = cvt_pk_bf16(o[2], o[3]);
                *(u32x2*)(S0 + (size_t)row * D_ + c0) = w;
            }
        }
    }
    xcd_barrier(bar);

    {
        Gemm g; g.A = S0; g.Bt = Win; g.A2 = S0; g.Bt2 = Win; g.K = 1024;
        Order od; od.nM = T_ / BM; od.nN = 9216 / BM; od.nwg = od.nM * od.nN; od.G = G; od.c = bid; od.dup = 1;
        EpiInProj e; e.sbase = S1; e.u = S6; e.gbase = GA; e.pos = p.pos;
        gemm_phase(lds, g, od, e);
    }
    xcd_barrier(bar);

    {
        for (int item = bid; item < 192; item += G) {
            const int bh = item / 3, gI = item % 3, bI = bh >> 3, hI = bh & 7;
            const float lg = log2f(1.0f - exp2f(-5.0f - (float)hI));
            const float g128 = exp2f(lg * 128.0f);
            f32x4 accR[8];
#pragma unroll
            for (int et = 0; et < 8; ++et) accR[et] = (f32x4){0.f, 0.f, 0.f, 0.f};
            for (int ci = 0; ci < 4; ++ci) {
                const size_t t0 = (size_t)bI * 2048 + (size_t)(4 * gI + ci) * 128;
                u32x4 kr[4], vr[4];
#pragma unroll
                for (int i = 0; i < 4; ++i) { const int r = (tid >> 4) + 32 * i, ch = tid & 15; const size_t off = (t0 + r) * D_ + hI * 128 + 8 * ch;
                    kr[i] = *(const u32x4*)(S2 + off); vr[i] = *(const u32x4*)(S3 + off); }
#pragma unroll
                for (int i = 0; i < 4; ++i) { const int r = (tid >> 4) + 32 * i, ch = tid & 15;
                    *(LAS u32x4*)(lds + KIMG + r * IMG_STRIDE + ch * 16) = kr[i]; *(LAS u32x4*)(lds + VIMG + r * IMG_STRIDE + ch * 16) = vr[i]; }
                __syncthreads();
                kv_update(lds, accR, wave, lane);
#pragma unroll
                for (int et = 0; et < 8; ++et) accR[et] = accR[et] * g128;
                __syncthreads();
            }
            float* gp = Gbuf + ((size_t)item * 8 + wave) * 2048 + lane;
#pragma unroll
            for (int et = 0; et < 8; ++et)
#pragma unroll
                for (int r = 0; r < 4; ++r) gp[(et * 4 + r) * 64] = accR[et][r];
        }
        __syncthreads();
        {
            LAS float* scr = (LAS float*)(lds + wave * 8448);
            const int gw = bid * 8 + wave, NGW = G * 8;
            constexpr int I_GU = 16 * 176, I_D = 44 * 32;
            for (int it = gw; it < I_GU + I_D; it += NGW) {
                int r = it;
                if (r < I_GU) { const int kb = r / 176, nb = r % 176; const int j0 = 32 * nb, pn = j0 >> 8, bj = (j0 >> 7) & 1, cp = j0 & 127;
                    transpose_item((bj ? p.w_up : p.w_gate) + (size_t)(64 * kb) * FH + pn * 128 + cp, FH, Wgu + (size_t)j0 * 1024 + 64 * kb, 1024, scr, lane); continue; }
                r -= I_GU;
                const int kb = r / 32, nb = r % 32;
                transpose_item(p.w_down + (size_t)(64 * kb) * 1024 + 32 * nb, 1024, Wd + (size_t)(32 * nb) * FH + 64 * kb, FH, scr, lane);
            }
        }
        for (int idx = bid * 512 + tid; idx < T_ * 128; idx += G * 512) {
            const int t = idx >> 7, c0 = (idx & 127) * 8, s = t & 2047;
            const size_t off = (size_t)t * D_ + c0;
            const u32x4 bv = *(const u32x4*)(S5 + off);
            const u32x4 u0 = *(const u32x4*)(S6 + off);
            u32x4 u1 = (u32x4){0u, 0u, 0u, 0u}, u2 = (u32x4){0u, 0u, 0u, 0u};
            if (s >= 1) u1 = *(const u32x4*)(S6 + off - D_);
            if (s >= 2) u2 = *(const u32x4*)(S6 + off - 2 * D_);
            const f32x4 w0a = *(const f32x4*)(p.conv_w + c0), w0b = *(const f32x4*)(p.conv_w + c0 + 4);
            const f32x4 w1a = *(const f32x4*)(p.conv_w + 1024 + c0), w1b = *(const f32x4*)(p.conv_w + 1024 + c0 + 4);
            const f32x4 w2a = *(const f32x4*)(p.conv_w + 2048 + c0), w2b = *(const f32x4*)(p.conv_w + 2048 + c0 + 4);
            const unsigned bw[4] = {bv.x, bv.y, bv.z, bv.w}, a0[4] = {u0.x, u0.y, u0.z, u0.w}, a1[4] = {u1.x, u1.y, u1.z, u1.w}, a2[4] = {u2.x, u2.y, u2.z, u2.w};
            float o[8];
#pragma unroll
            for (int e = 0; e < 8; ++e) {
                const int wi = e >> 1; const bool hi = e & 1;
                const float ub = hi ? bf_hi(bw[wi]) : bf_lo(bw[wi]);
                const float x0 = hi ? bf_hi(a0[wi]) : bf_lo(a0[wi]), x1 = hi ? bf_hi(a1[wi]) : bf_lo(a1[wi]), x2 = hi ? bf_hi(a2[wi]) : bf_lo(a2[wi]);
                const float k0 = e < 4 ? w0a[e & 3] : w0b[e & 3], k1 = e < 4 ? w1a[e & 3] : w1b[e & 3], k2 = e < 4 ? w2a[e & 3] : w2b[e & 3];
                o[e] = ub * (x2 * k0 + x1 * k1 + x0 * k2);
            }
            u32x4 w; w.x = cvt_pk_bf16(o[0], o[1]); w.y = cvt_pk_bf16(o[2], o[3]); w.z = cvt_pk_bf16(o[4], o[5]); w.w = cvt_pk_bf16(o[6], o[7]);
            *(u32x4*)(S5 + off) = w;
        }
    }
    xcd_barrier(bar);

    for (int item = bid; item < 256; item += G) {
        const int bh = item >> 2, gI = item & 3, bI = bh >> 3, hI = bh & 7;
        const int w = wave, g4 = lane >> 4, l15 = lane & 15, q = l15 >> 2, pp = lane & 3;
        const float lg = log2f(1.0f - exp2f(-5.0f - (float)hI));
        const float g128 = exp2f(lg * 128.0f);
        f32x4 accR[8];
#pragma unroll
        for (int et = 0; et < 8; ++et) accR[et] = (f32x4){0.f, 0.f, 0.f, 0.f};
        for (int gg = 0; gg < gI; ++gg) {
            const float coef = exp2f(lg * 512.0f * (float)(gI - 1 - gg));
            const float* gp = Gbuf + ((size_t)(bh * 3 + gg) * 8 + w) * 2048 + lane;
#pragma unroll
            for (int et = 0; et < 8; ++et)
#pragma unroll
                for (int r = 0; r < 4; ++r) accR[et][r] += coef * gp[(et * 4 + r) * 64];
        }
        u32x4 kr[4], vr[4];
        {
            const size_t t0 = (size_t)bI * 2048 + (size_t)(4 * gI) * 128;
#pragma unroll
            for (int i = 0; i < 4; ++i) { const int r = (tid >> 4) + 32 * i, ch = tid & 15; const size_t off = (t0 + r) * D_ + hI * 128 + 8 * ch;
                kr[i] = *(const u32x4*)(S2 + off); vr[i] = *(const u32x4*)(S3 + off); }
        }
        for (int ci = 0; ci < 4; ++ci) {
            const size_t t0 = (size_t)bI * 2048 + (size_t)(4 * gI + ci) * 128;
            const size_t rowoff = (t0 + 16 * w + l15) * D_ + hI * 128;
            bf16x8 qf[4];
#pragma unroll
            for (int s = 0; s < 4; ++s) qf[s] = *(const bf16x8*)(S1 + rowoff + 32 * s + 8 * g4);
#pragma unroll
            for (int i = 0; i < 4; ++i) { const int r = (tid >> 4) + 32 * i, ch = tid & 15;
                *(LAS u32x4*)(lds + KIMG + r * IMG_STRIDE + ch * 16) = kr[i]; *(LAS u32x4*)(lds + VIMG + r * IMG_STRIDE + ch * 16) = vr[i]; }
#pragma unroll
            for (int et = 0; et < 8; ++et) {
                u32x2 wv; wv.x = cvt_pk_bf16(accR[et][0], accR[et][1]); wv.y = cvt_pk_bf16(accR[et][2], accR[et][3]);
                *(LAS u32x2*)(lds + RIMG + (16 * et + l15) * IMG_STRIDE + (16 * w + 4 * g4) * 2) = wv;
            }
            __syncthreads();
            if (ci < 3) {
                const size_t t1 = t0 + 128;
#pragma unroll
                for (int i = 0; i < 4; ++i) { const int r = (tid >> 4) + 32 * i, ch = tid & 15; const size_t off = (t1 + r) * D_ + hI * 128 + 8 * ch;
                    kr[i] = *(const u32x4*)(S2 + off); vr[i] = *(const u32x4*)(S3 + off); }
            }
            f32x4 accS[8], accO[8];
#pragma unroll
            for (int i = 0; i < 8; ++i) { accS[i] = (f32x4){0.f, 0.f, 0.f, 0.f}; accO[i] = (f32x4){0.f, 0.f, 0.f, 0.f}; }
#pragma unroll
            for (int mt = 0; mt < 8; ++mt) {
                if (mt <= w) {
#pragma unroll
                    for (int s = 0; s < 4; ++s) {
                        const bf16x8 af = *(const LAS bf16x8*)(lds + KIMG + (16 * mt + l15) * IMG_STRIDE + (32 * s + 8 * g4) * 2);
                        accS[mt] = __builtin_amdgcn_mfma_f32_16x16x32_bf16(af, qf[s], accS[mt], 0, 0, 0);
                    }
                }
            }
#pragma unroll
            for (int et = 0; et < 8; ++et)
#pragma unroll
                for (int s = 0; s < 4; ++s) {
                    const bf16x8 af = *(const LAS bf16x8*)(lds + RIMG + (16 * et + l15) * IMG_STRIDE + (32 * s + 8 * g4) * 2);
                    accO[et] = __builtin_amdgcn_mfma_f32_16x16x32_bf16(af, qf[s], accO[et], 0, 0, 0);
                }
            bf16x8 pf[4];
#pragma unroll
            for (int s = 0; s < 4; ++s) {
                f32x4 lo = accS[2 * s], hi = accS[2 * s + 1];
                if (2 * s == w) {
#pragma unroll
                    for (int r = 0; r < 4; ++r) lo[r] = (4 * g4 + r <= l15) ? lo[r] : 0.f;
                }
                if (2 * s + 1 == w) {
#pragma unroll
                    for (int r = 0; r < 4; ++r) hi[r] = (4 * g4 + r <= l15) ? hi[r] : 0.f;
                }
                u32x4 pk; pk.x = cvt_pk_bf16(lo[0], lo[1]); pk.y = cvt_pk_bf16(lo[2], lo[3]); pk.z = cvt_pk_bf16(hi[0], hi[1]); pk.w = cvt_pk_bf16(hi[2], hi[3]);
                pf[s] = __builtin_bit_cast(bf16x8, pk);
            }
#pragma unroll
            for (int s = 0; s < 4; ++s) {
                if (2 * s <= w) {
#pragma unroll
                    for (int et = 0; et < 8; ++et) {
                        const bf16x8 af = tr_frag(lds + VIMG, 32 * s + 4 * g4 + q, 32 * s + 16 + 4 * g4 + q, (16 * et + 4 * pp) * 2);
                        accO[et] = __builtin_amdgcn_mfma_f32_16x16x32_bf16(af, pf[s], accO[et], 0, 0, 0);
                    }
                }
            }
            {
                float s1 = 0.f;
#pragma unroll
                for (int et = 0; et < 8; ++et) s1 += (accO[et][0] + accO[et][1]) + (accO[et][2] + accO[et][3]);
                s1 += __shfl_xor(s1, 16); s1 += __shfl_xor(s1, 32);
                const float mu = s1 * (1.0f / 128.0f);
                float s2 = 0.f;
#pragma unroll
                for (int et = 0; et < 8; ++et) { const f32x4 d = accO[et] - mu; s2 += (d[0] * d[0] + d[1] * d[1]) + (d[2] * d[2] + d[3] * d[3]); }
                s2 += __shfl_xor(s2, 16); s2 += __shfl_xor(s2, 32);
                const float rstd = 1.0f / sqrtf(s2 * (1.0f / 128.0f) + EPS);
                bf16_t* gp = S4 + rowoff + 4 * g4;
#pragma unroll
                for (int et = 0; et < 8; ++et) {
                    const u32x2 gv = *(const u32x2*)(gp + 16 * et);
                    const f32x4 y = (accO[et] - mu) * rstd;
                    u32x2 o; o.x = cvt_pk_bf16(y[0] * bf_lo(gv.x), y[1] * bf_hi(gv.x)); o.y = cvt_pk_bf16(y[2] * bf_lo(gv.y), y[3] * bf_hi(gv.y));
                    *(u32x2*)(gp + 16 * et) = o;
                }
            }
            if (ci < 3) {
                kv_update(lds, accR, w, lane);
#pragma unroll
                for (int et = 0; et < 8; ++et) accR[et] = accR[et] * g128;
            }
            __syncthreads();
        }
    }
    xcd_barrier(bar);

    {
        Gemm g; g.A = S4; g.Bt = Wr; g.A2 = S5; g.Bt2 = Wc; g.K = 1024;
        Order od; od.nM = T_ / BM; od.nN = 1024 / BM; od.nwg = od.nM * od.nN; od.G = G; od.c = bid; od.dup = 2;
        EpiMerge e; e.ga = GA; e.gb = GB; e.merged = S0;
        gemm_phase(lds, g, od, e);
    }
    xcd_barrier(bar);

    {
        Gemm g; g.A = S0; g.Bt = Wmix; g.A2 = S0; g.Bt2 = Wmix; g.K = 1024;
        Order od; od.nM = T_ / BM; od.nN = 1024 / BM; od.nwg = od.nM * od.nN; od.G = G; od.c = bid; od.dup = 1;
        EpiResid e; e.xi = p.x; e.xo = p.out; e.gate = mod + 2048; e.ss = ss1;
        gemm_phase(lds, g, od, e);
    }
    xcd_barrier(bar);

    {
        const int gw = bid * 8 + wave, NGW = G * 8;
        for (int row = gw; row < T_; row += NGW) {
            const float* xr = p.out + (size_t)row * D_;
            const float* mb = mod + (size_t)(row >> 11) * 6144;
            const float rstd = 1.0f / sqrtf(ss1[row] * (1.0f / D_) + EPS);
#pragma unroll
            for (int j = 0; j < 4; ++j) {
                const int c0 = 4 * lane + 256 * j;
                const f32x4 xv = *(const f32x4*)(xr + c0);
                const f32x4 gv = *(const f32x4*)(p.g_ffn + c0), sh = *(const f32x4*)(mb + 3072 + c0), sc = *(const f32x4*)(mb + 4096 + c0);
                const f32x4 y = (xv * rstd) * gv;
                const f32x4 o = y * (sc + 1.0f) + sh;
                u32x2 wv; wv.x = cvt_pk_bf16(o[0], o[1]); wv.y = cvt_pk_bf16(o[2], o[3]);
                *(u32x2*)(S1 + (size_t)row * D_ + c0) = wv;
            }
        }
    }
    xcd_barrier(bar);

    {
        Gemm g; g.A = S1; g.Bt = Wgu; g.A2 = S1; g.Bt2 = Wgu; g.K = 1024;
        Order od; od.nM = T_ / BM; od.nN = 5632 / BM; od.nwg = od.nM * od.nN; od.G = G; od.c = bid; od.dup = 1;
        EpiGU e; e.act = S2;
        gemm_phase(lds, g, od, e);
    }
    xcd_barrier(bar);

    {
        Gemm g; g.A = S2; g.Bt = Wd; g.A2 = S2; g.Bt2 = Wd; g.K = FH;
        Order od; od.nM = T_ / BM; od.nN = 1024 / BM; od.nwg = od.nM * od.nN; od.G = G; od.c = bid; od.dup = 1;
        EpiResid e; e.xi = p.out; e.xo = p.out; e.gate = mod + 5120; e.ss = ss2;
        gemm_phase(lds, g, od, e);
    }
    xcd_barrier(bar);

    {
        const int gw = bid * 8 + wave, NGW = G * 8;
        for (int row = gw; row < T_; row += NGW) {
            float* xr = p.out + (size_t)row * D_;
            const float rstd = 1.0f / sqrtf(ss2[row] * (1.0f / D_) + EPS);
#pragma unroll
            for (int j = 0; j < 4; ++j) {
                const int c0 = 4 * lane + 256 * j;
                const f32x4 xv = *(const f32x4*)(xr + c0);
                const f32x4 gv = *(const f32x4*)(p.g_fin + c0);
                *(f32x4*)(xr + c0) = (xv * rstd) * gv;
            }
        }
    }
}

extern "C" void kernel_launch(void* const* d_in, const int* in_sizes, int n_in, void* d_out, int out_size, void* d_ws, size_t ws_size, hipStream_t stream) {
    static int grid = 0;
    if (grid == 0) {
        if (n_in != 16 || ws_size < WS_END) { fprintf(stderr, "kernel_launch: unexpected problem (n_in %d, ws %zu)\n", n_in, ws_size); grid = -1; return; }
        int dev = 0, cus = 0, per_cu = 0;
        (void)hipGetDevice(&dev);
        (void)hipDeviceGetAttribute(&cus, hipDeviceAttributeMultiprocessorCount, dev);
        if (hipFuncSetAttribute((const void*)mega, hipFuncAttributeMaxDynamicSharedMemorySize, LDS_BYTES) != hipSuccess) { fprintf(stderr, "kernel_launch: hipFuncSetAttribute failed\n"); grid = -1; return; }
        (void)hipOccupancyMaxActiveBlocksPerMultiprocessor(&per_cu, (const void*)mega, 512, LDS_BYTES);
        (void)hipGetLastError();
        if (per_cu < 1) fprintf(stderr, "kernel_launch: occupancy query reports %d blocks per CU\n", per_cu);
        grid = cus;
    }
    if (grid < 0) return;
    (void)hipMemsetAsync((char*)d_ws + WS_CTL, 0, 16384, stream);
    Params p{};
    p.x = (const float*)d_in[0]; p.c = (const float*)d_in[1]; p.pos = (const int*)d_in[2]; p.ada_w = (const float*)d_in[3]; p.ada_b = (const float*)d_in[4];
    p.g_mix = (const float*)d_in[5]; p.w_in = (const float*)d_in[6]; p.conv_w = (const float*)d_in[7]; p.w_ret = (const float*)d_in[8]; p.w_conv = (const float*)d_in[9];
    p.w_mix = (const float*)d_in[10]; p.g_ffn = (const float*)d_in[11]; p.w_gate = (const float*)d_in[12]; p.w_up = (const float*)d_in[13]; p.w_down = (const float*)d_in[14];
    p.g_fin = (const float*)d_in[15];
    p.out = (float*)d_out; p.ws = (unsigned char*)d_ws; p.never = 0; p.pad = 0;
    void* args[] = {&p};
    hipError_t e = hipLaunchCooperativeKernel((const void*)mega, dim3(grid), dim3(512), args, LDS_BYTES, stream);
    if (e != hipSuccess) fprintf(stderr, "kernel_launch: cooperative launch failed: %s (grid %d)\n", hipGetErrorString(e), grid);
}
```
